# Optimizing an MI355X kernel written in HIP

```python
import math
import jax, jax.numpy as jnp
from jax import lax
import numpy as np

D_MODEL = 1024
BATCH = 8
SEQ = 4096
DEPTH = 1

N_META = 16
CONV_WIDTH = 1024
CONV_GROUPS = 16
CONV_K = 3
N_DIFF_HEADS = 8
DIFF_HEAD_DIM = 64
ATTN_QK_WIDTH = N_DIFF_HEADS * 2 * DIFF_HEAD_DIM
ATTN_V_WIDTH = N_DIFF_HEADS * 2 * DIFF_HEAD_DIM
IN_PROJ_WIDTH = 3 * CONV_WIDTH + 2 * ATTN_QK_WIDTH + ATTN_V_WIDTH + 2 * D_MODEL
D_FF = 2816
FFN_CONV_K = 3
Q_BLOCK = 128
RMS_EPS = 1e-6
NEG_INF = -1e30

kernel_name = "hybrid_shortconv_diffattn_gated_merge"


def rmsnorm(x, g):
    xf = x.astype(jnp.float32)
    y = xf * lax.rsqrt(jnp.mean(xf * xf, axis=-1, keepdims=True) + RMS_EPS)
    return (y * g.astype(jnp.float32)).astype(x.dtype)


def causal_dwconv(x, w, b=None):
    K = w.shape[0]
    L = x.shape[1]
    xp = jnp.pad(x, ((0, 0), (K - 1, 0), (0, 0)))
    y = xp[:, 0:L] * w[0]
    for k in range(1, K):
        y = y + xp[:, k:k + L] * w[k]
    if b is not None:
        y = y + b
    return y


def alibi_slopes(n_heads):
    return 2.0 ** (-8.0 * jnp.arange(1, n_heads + 1, dtype=jnp.float32) / n_heads)


def diff_attention(q, k, v, lam, lam_init, subln_g):
    B, L, H, _, dh = q.shape
    Lp = -(-L // Q_BLOCK) * Q_BLOCK
    q = jnp.pad(q, ((0, 0), (0, Lp - L), (0, 0), (0, 0), (0, 0)))
    k = jnp.pad(k, ((0, 0), (0, Lp - L), (0, 0), (0, 0), (0, 0)))
    v = jnp.pad(v, ((0, 0), (0, Lp - L), (0, 0), (0, 0)))
    nb = Lp // Q_BLOCK
    qb = q.reshape(B, nb, Q_BLOCK, H, 2, dh).transpose(1, 0, 2, 3, 4, 5)
    slopes = alibi_slopes(H)
    k_pos = jnp.arange(Lp)
    scale = dh ** -0.5

    def block(args):
        qi, i = args
        q_pos = i * Q_BLOCK + jnp.arange(Q_BLOCK)
        dist = (q_pos[:, None] - k_pos[None, :]).astype(jnp.float32)
        bias = -slopes[:, None, None] * dist
        causal = k_pos[None, :] <= q_pos[:, None]
        s = jnp.einsum('bqhmd,bkhmd->bhmqk', qi, k).astype(jnp.float32) * scale
        s = jnp.where(causal, s + bias[None, :, None], NEG_INF)
        p = jax.nn.softmax(s, axis=-1)
        w = p[:, :, 0] - lam * p[:, :, 1]
        return jnp.einsum('bhqk,bkhe->bqhe', w.astype(v.dtype), v)

    o = lax.map(block, (qb, jnp.arange(nb)))
    o = o.transpose(1, 0, 2, 3, 4).reshape(B, Lp, H, 2 * dh)[:, :L]
    o = rmsnorm(o, subln_g) * (1.0 - lam_init)
    return o.reshape(B, L, H * 2 * dh)


def setup_inputs(seed: int = 0) -> dict:
    key = jax.random.key(seed)
    ks = jax.random.split(key, 24)
    f32 = jnp.float32

    def nrm(k, shape, scale):
        return jax.random.normal(k, shape, f32) * scale

    def gain(k, shape):
        return 1.0 + 0.05 * jax.random.normal(k, shape, f32)

    L = DEPTH
    return {
        "x": nrm(ks[0], (BATCH, SEQ, D_MODEL), 1.0),
        "meta_tokens": nrm(ks[1], (N_META, D_MODEL), 1.0),
        "w_in": nrm(ks[2], (L, D_MODEL, IN_PROJ_WIDTH), D_MODEL ** -0.5),
        "conv_w": nrm(ks[3], (L, CONV_K, CONV_WIDTH), CONV_K ** -0.5),
        "w_conv_out": nrm(ks[4], (L, CONV_WIDTH, D_MODEL), CONV_WIDTH ** -0.5),
        "lambda_q1": nrm(ks[5], (L, DIFF_HEAD_DIM), 0.1),
        "lambda_k1": nrm(ks[6], (L, DIFF_HEAD_DIM), 0.1),
        "lambda_q2": nrm(ks[7], (L, DIFF_HEAD_DIM), 0.1),
        "lambda_k2": nrm(ks[8], (L, DIFF_HEAD_DIM), 0.1),
        "subln_g": gain(ks[9], (L, 2 * DIFF_HEAD_DIM)),
        "w_attn_out": nrm(ks[10], (L, ATTN_V_WIDTH, D_MODEL), ATTN_V_WIDTH ** -0.5),
        "w_mix_out": nrm(ks[11], (L, D_MODEL, D_MODEL), D_MODEL ** -0.5),
        "norm_mix_pre": gain(ks[12], (L, D_MODEL)),
        "norm_mix_post": gain(ks[13], (L, D_MODEL)),
        "w_ffn_up": nrm(ks[14], (L, D_MODEL, 2 * D_FF), D_MODEL ** -0.5),
        "ffn_conv_w": nrm(ks[15], (L, FFN_CONV_K, 2 * D_FF), FFN_CONV_K ** -0.5),
        "ffn_conv_b": nrm(ks[16], (L, 2 * D_FF), 0.01),
        "w_ffn_down": nrm(ks[17], (L, D_FF, D_MODEL), D_FF ** -0.5),
        "norm_ffn_pre": gain(ks[18], (L, D_MODEL)),
        "norm_ffn_post": gain(ks[19], (L, D_MODEL)),
    }


def reference(x, meta_tokens, w_in, conv_w, w_conv_out, lambda_q1, lambda_k1, lambda_q2, lambda_k2,
              subln_g, w_attn_out, w_mix_out, norm_mix_pre, norm_mix_post, w_ffn_up, ffn_conv_w,
              ffn_conv_b, w_ffn_down, norm_ffn_pre, norm_ffn_post):
    B = x.shape[0]
    h = jnp.concatenate(
        [jnp.broadcast_to(meta_tokens[None].astype(x.dtype), (B, N_META, D_MODEL)), x], axis=1)
    Ltot = h.shape[1]
    sizes = [CONV_WIDTH] * 3 + [ATTN_QK_WIDTH] * 2 + [ATTN_V_WIDTH] + [D_MODEL] * 2
    split_idx = np.cumsum(sizes)[:-1].tolist()
    for l in range(DEPTH):
        lam_init = 0.8 - 0.6 * math.exp(-0.3 * l)
        a = rmsnorm(h, norm_mix_pre[l])
        proj = a @ w_in[l]
        cb, cc, cx, q, k, v, ga, gb = jnp.split(proj, split_idx, axis=-1)
        ya = (cb * causal_dwconv(cc * cx, conv_w[l])) @ w_conv_out[l]
        lam = (jnp.exp(jnp.sum(lambda_q1[l].astype(jnp.float32) * lambda_k1[l].astype(jnp.float32)))
               - jnp.exp(jnp.sum(lambda_q2[l].astype(jnp.float32) * lambda_k2[l].astype(jnp.float32)))
               + lam_init)
        q = q.reshape(B, Ltot, N_DIFF_HEADS, 2, DIFF_HEAD_DIM)
        k = k.reshape(B, Ltot, N_DIFF_HEADS, 2, DIFF_HEAD_DIM)
        v = v.reshape(B, Ltot, N_DIFF_HEADS, 2 * DIFF_HEAD_DIM)
        yb = diff_attention(q, k, v, lam, lam_init, subln_g[l]) @ w_attn_out[l]
        mix = (jax.nn.sigmoid(ga) * ya + jax.nn.sigmoid(gb) * yb) @ w_mix_out[l]
        h = h + rmsnorm(mix, norm_mix_post[l])
        f = rmsnorm(h, norm_ffn_pre[l])
        u = causal_dwconv(f @ w_ffn_up[l], ffn_conv_w[l], ffn_conv_b[l])
        g, u = jnp.split(u, 2, axis=-1)
        y = (jax.nn.silu(g) * u) @ w_ffn_down[l]
        h = h + rmsnorm(y, norm_ffn_post[l])
    return h[:, N_META:]
```

```cpp
#include <hip/hip_runtime.h>
#include <cstdio>
#include <cstdint>
#include <cmath>

constexpr int D = 1024, BATCH = 8, SEQ = 4096, NMETA = 16, LTOT = SEQ + NMETA;
constexpr int NPROJ = 8192, DFF = 2816, NUP = 2 * DFF, H = 8, DH = 64;
constexpr float EPS = 1e-6f;

__device__ __forceinline__ float block_sum_256(float v, float* red) {
    for (int o = 32; o > 0; o >>= 1) v += __shfl_xor(v, o);
    const int w = threadIdx.x >> 6;
    __syncthreads();
    if ((threadIdx.x & 63) == 0) red[w] = v;
    __syncthreads();
    return red[0] + red[1] + red[2] + red[3];
}

__global__ void __launch_bounds__(256) k_build_norm(const float* __restrict__ x_b, const float* __restrict__ meta, const float* __restrict__ g,
                                                    float* __restrict__ h_b, float* __restrict__ a_b) {
    __shared__ float red[4];
    const int r = blockIdx.x, t = threadIdx.x;
    const float* src = r < NMETA ? meta + (size_t)r * D : x_b + (size_t)(r - NMETA) * D;
    const float4 v = ((const float4*)src)[t];
    const float ss = block_sum_256(v.x * v.x + v.y * v.y + v.z * v.z + v.w * v.w, red);
    const float rs = rsqrtf(ss * (1.f / D) + EPS);
    const float4 gg = ((const float4*)g)[t];
    ((float4*)(h_b + (size_t)r * D))[t] = v;
    ((float4*)(a_b + (size_t)r * D))[t] = make_float4(v.x * rs * gg.x, v.y * rs * gg.y, v.z * rs * gg.z, v.w * rs * gg.w);
}

__global__ void __launch_bounds__(256) k_res_norm(const float* __restrict__ base, const float* __restrict__ y, const float* __restrict__ g,
                                                  float* __restrict__ out, const float* __restrict__ g2, float* __restrict__ f) {
    __shared__ float red[4];
    const int r = blockIdx.x, t = threadIdx.x;
    const float4 v = ((const float4*)(y + (size_t)r * D))[t];
    const float ss = block_sum_256(v.x * v.x + v.y * v.y + v.z * v.z + v.w * v.w, red);
    const float rs = rsqrtf(ss * (1.f / D) + EPS);
    const float4 gg = ((const float4*)g)[t];
    const float4 b = ((const float4*)(base + (size_t)r * D))[t];
    float4 o = make_float4(b.x + v.x * rs * gg.x, b.y + v.y * rs * gg.y, b.z + v.z * rs * gg.z, b.w + v.w * rs * gg.w);
    ((float4*)(out + (size_t)r * D))[t] = o;
    if (f) {
        const float s2 = block_sum_256(o.x * o.x + o.y * o.y + o.z * o.z + o.w * o.w, red);
        const float r2 = rsqrtf(s2 * (1.f / D) + EPS);
        const float4 g3 = ((const float4*)g2)[t];
        ((float4*)(f + (size_t)r * D))[t] = make_float4(o.x * r2 * g3.x, o.y * r2 * g3.y, o.z * r2 * g3.z, o.w * r2 * g3.w);
    }
}

__global__ void __launch_bounds__(256) k_final(const float* __restrict__ base, const float* __restrict__ y, const float* __restrict__ g, float* __restrict__ out_b) {
    __shared__ float red[4];
    const int r = blockIdx.x + NMETA, t = threadIdx.x;
    const float4 v = ((const float4*)(y + (size_t)r * D))[t];
    const float ss = block_sum_256(v.x * v.x + v.y * v.y + v.z * v.z + v.w * v.w, red);
    const float rs = rsqrtf(ss * (1.f / D) + EPS);
    const float4 gg = ((const float4*)g)[t];
    const float4 b = ((const float4*)(base + (size_t)r * D))[t];
    ((float4*)(out_b + (size_t)(r - NMETA) * D))[t] = make_float4(b.x + v.x * rs * gg.x, b.y + v.y * rs * gg.y, b.z + v.z * rs * gg.z, b.w + v.w * rs * gg.w);
}

__global__ void __launch_bounds__(256) k_gemm(const float* __restrict__ A, int lda, const float* __restrict__ B, int ldb, float* __restrict__ C, int ldc, int M, int N, int K) {
    __shared__ float As[16][132];
    __shared__ float Bs[16][132];
    const int tid = threadIdx.x, tx = tid & 15, ty = tid >> 4;
    const int m0 = blockIdx.y * 128, n0 = blockIdx.x * 128;
    float acc[8][8];
#pragma unroll
    for (int i = 0; i < 8; ++i)
#pragma unroll
        for (int j = 0; j < 8; ++j) acc[i][j] = 0.f;
    const int ar = tid >> 1, ak = (tid & 1) * 8;
    const int bk = tid >> 4, bn = (tid & 15) * 8;
    const bool arow_ok = (m0 + ar) < M;
    const float* Ap = A + (size_t)(m0 + ar) * lda + ak;
    const float* Bp = B + (size_t)bk * ldb + n0 + bn;
    for (int k0 = 0; k0 < K; k0 += 16) {
        float4 a0 = make_float4(0, 0, 0, 0), a1 = a0;
        if (arow_ok) { a0 = *(const float4*)(Ap + k0); a1 = *(const float4*)(Ap + k0 + 4); }
        const float4 b0 = *(const float4*)(Bp + (size_t)k0 * ldb), b1 = *(const float4*)(Bp + (size_t)k0 * ldb + 4);
        __syncthreads();
        As[ak + 0][ar] = a0.x; As[ak + 1][ar] = a0.y; As[ak + 2][ar] = a0.z; As[ak + 3][ar] = a0.w;
        As[ak + 4][ar] = a1.x; As[ak + 5][ar] = a1.y; As[ak + 6][ar] = a1.z; As[ak + 7][ar] = a1.w;
        *(float4*)&Bs[bk][bn] = b0; *(float4*)&Bs[bk][bn + 4] = b1;
        __syncthreads();
#pragma unroll
        for (int k = 0; k < 16; ++k) {
            float a[8], b[8];
            *(float4*)&a[0] = *(const float4*)&As[k][ty * 4]; *(float4*)&a[4] = *(const float4*)&As[k][64 + ty * 4];
            *(float4*)&b[0] = *(const float4*)&Bs[k][tx * 4]; *(float4*)&b[4] = *(const float4*)&Bs[k][64 + tx * 4];
#pragma unroll
            for (int i = 0; i < 8; ++i)
#pragma unroll
                for (int j = 0; j < 8; ++j) acc[i][j] = fmaf(a[i], b[j], acc[i][j]);
        }
    }
#pragma unroll
    for (int i = 0; i < 8; ++i) {
        const int r = m0 + (i < 4 ? ty * 4 + i : 64 + ty * 4 + i - 4);
        if (r < M) {
            *(float4*)(C + (size_t)r * ldc + n0 + tx * 4) = make_float4(acc[i][0], acc[i][1], acc[i][2], acc[i][3]);
            *(float4*)(C + (size_t)r * ldc + n0 + 64 + tx * 4) = make_float4(acc[i][4], acc[i][5], acc[i][6], acc[i][7]);
        }
    }
}

__global__ void __launch_bounds__(256) k_convmix(const float* __restrict__ proj, const float* __restrict__ w, float* __restrict__ cm) {
    const int t = blockIdx.x;
    for (int c = threadIdx.x; c < D; c += 256) {
        float acc = 0.f;
#pragma unroll
        for (int k = 0; k < 3; ++k) {
            const int tt = t - 2 + k;
            if (tt >= 0) { const float* p = proj + (size_t)tt * NPROJ; acc += w[k * D + c] * (p[D + c] * p[2 * D + c]); }
        }
        cm[(size_t)t * D + c] = proj[(size_t)t * NPROJ + c] * acc;
    }
}

__global__ void __launch_bounds__(64) k_attn(const float* __restrict__ proj, const float* __restrict__ lq1, const float* __restrict__ lk1, const float* __restrict__ lq2,
                                             const float* __restrict__ lk2, const float* __restrict__ subg, float* __restrict__ on) {
    __shared__ float sc[2][LTOT];
    __shared__ float qs[128];
    const int i = blockIdx.x, h = blockIdx.y, lane = threadIdx.x;
    float a = lq1[lane] * lk1[lane], b = lq2[lane] * lk2[lane];
    for (int o = 32; o > 0; o >>= 1) { a += __shfl_xor(a, o); b += __shfl_xor(b, o); }
    const float lam_init = 0.2f;
    const float lam = expf(a) - expf(b) + lam_init;
    const float* qrow = proj + (size_t)i * NPROJ + 3 * D + h * 128;
    qs[lane] = qrow[lane]; qs[lane + 64] = qrow[lane + 64];
    __syncthreads();
    const float slope = exp2f(-(float)(h + 1));
    float m0 = -1e30f, m1 = -1e30f;
    for (int j = lane; j <= i; j += 64) {
        const float4* kr = (const float4*)(proj + (size_t)j * NPROJ + 4 * D + h * 128);
        float s0 = 0.f, s1 = 0.f;
#pragma unroll
        for (int d = 0; d < 16; ++d) { const float4 kv = kr[d]; s0 += qs[4 * d] * kv.x + qs[4 * d + 1] * kv.y + qs[4 * d + 2] * kv.z + qs[4 * d + 3] * kv.w; }
#pragma unroll
        for (int d = 0; d < 16; ++d) { const float4 kv = kr[16 + d]; s1 += qs[64 + 4 * d] * kv.x + qs[64 + 4 * d + 1] * kv.y + qs[64 + 4 * d + 2] * kv.z + qs[64 + 4 * d + 3] * kv.w; }
        const float bias = -slope * (float)(i - j);
        s0 = s0 * 0.125f + bias; s1 = s1 * 0.125f + bias;
        sc[0][j] = s0; sc[1][j] = s1;
        m0 = fmaxf(m0, s0); m1 = fmaxf(m1, s1);
    }
    for (int o = 32; o > 0; o >>= 1) { m0 = fmaxf(m0, __shfl_xor(m0, o)); m1 = fmaxf(m1, __shfl_xor(m1, o)); }
    float l0 = 0.f, l1 = 0.f;
    for (int j = lane; j <= i; j += 64) {
        const float p0 = expf(sc[0][j] - m0), p1 = expf(sc[1][j] - m1);
        sc[0][j] = p0; sc[1][j] = p1; l0 += p0; l1 += p1;
    }
    for (int o = 32; o > 0; o >>= 1) { l0 += __shfl_xor(l0, o); l1 += __shfl_xor(l1, o); }
    __syncthreads();
    const float i0 = 1.f / l0, i1 = lam / l1;
    float o0 = 0.f, o1 = 0.f;
    const float* vbase = proj + 5 * D + h * 128 + lane * 2;
    for (int j = 0; j <= i; ++j) {
        const float w = sc[0][j] * i0 - sc[1][j] * i1;
        const float2 vv = *(const float2*)(vbase + (size_t)j * NPROJ);
        o0 = fmaf(w, vv.x, o0); o1 = fmaf(w, vv.y, o1);
    }
    float ss = o0 * o0 + o1 * o1;
    for (int o = 32; o > 0; o >>= 1) ss += __shfl_xor(ss, o);
    const float rs = rsqrtf(ss * (1.f / 128.f) + EPS) * (1.f - lam_init);
    float* op = on + (size_t)i * D + h * 128 + lane * 2;
    op[0] = o0 * rs * subg[lane * 2]; op[1] = o1 * rs * subg[lane * 2 + 1];
}

__global__ void __launch_bounds__(256) k_merge(const float* __restrict__ proj, const float* __restrict__ ya, const float* __restrict__ yb, float* __restrict__ mg) {
    const int t = blockIdx.x;
    for (int c = threadIdx.x; c < D; c += 256) {
        const float ga = proj[(size_t)t * NPROJ + 6 * D + c], gb = proj[(size_t)t * NPROJ + 7 * D + c];
        mg[(size_t)t * D + c] = ya[(size_t)t * D + c] / (1.f + expf(-ga)) + yb[(size_t)t * D + c] / (1.f + expf(-gb));
    }
}

__global__ void __launch_bounds__(256) k_ffnact(const float* __restrict__ up, const float* __restrict__ w, const float* __restrict__ bias, float* __restrict__ act) {
    const int t = blockIdx.x;
    for (int j = threadIdx.x; j < DFF; j += 256) {
        float g = bias[j], u = bias[DFF + j];
#pragma unroll
        for (int k = 0; k < 3; ++k) {
            const int tt = t - 2 + k;
            if (tt >= 0) { g += w[k * NUP + j] * up[(size_t)tt * NUP + j]; u += w[k * NUP + DFF + j] * up[(size_t)tt * NUP + DFF + j]; }
        }
        act[(size_t)t * DFF + j] = g / (1.f + expf(-g)) * u;
    }
}

extern "C" void kernel_launch(void* const* d_in, const int* in_sizes, int n_in, void* d_out, int out_size, void* d_ws, size_t ws_size, hipStream_t stream) {
    const float* x = (const float*)d_in[0]; const float* meta = (const float*)d_in[1]; const float* w_in = (const float*)d_in[2];
    const float* conv_w = (const float*)d_in[3]; const float* w_co = (const float*)d_in[4];
    const float* lq1 = (const float*)d_in[5]; const float* lk1 = (const float*)d_in[6]; const float* lq2 = (const float*)d_in[7]; const float* lk2 = (const float*)d_in[8];
    const float* subg = (const float*)d_in[9]; const float* w_ao = (const float*)d_in[10]; const float* w_mo = (const float*)d_in[11];
    const float* g_mpre = (const float*)d_in[12]; const float* g_mpost = (const float*)d_in[13]; const float* w_up = (const float*)d_in[14];
    const float* fcw = (const float*)d_in[15]; const float* fcb = (const float*)d_in[16]; const float* w_dn = (const float*)d_in[17];
    const float* g_fpre = (const float*)d_in[18]; const float* g_fpost = (const float*)d_in[19];
    float* out = (float*)d_out;
    float* ws = (float*)d_ws;
    const size_t RD = (size_t)LTOT * D;
    float* h_b = ws;
    float* a_b = h_b + RD;
    float* cm = a_b + RD;
    float* on = cm + RD;
    float* ya = on + RD;
    float* yb = ya + RD;
    float* mg = yb + RD;
    float* mix = mg + RD;
    float* h1 = mix + RD;
    float* f = h1 + RD;
    float* y = f + RD;
    float* act = y + RD;
    float* big = act + (size_t)LTOT * DFF;
    const size_t need = ((size_t)(big - ws) + (size_t)LTOT * NPROJ) * 4;
    if (need > ws_size) { fprintf(stderr, "ws too small: need %zu have %zu\n", need, ws_size); return; }
    const int MB = (LTOT + 127) / 128;
    for (int b = 0; b < BATCH; ++b) {
        const float* x_b = x + (size_t)b * SEQ * D;
        k_build_norm<<<LTOT, 256, 0, stream>>>(x_b, meta, g_mpre, h_b, a_b);
        k_gemm<<<dim3(NPROJ / 128, MB), 256, 0, stream>>>(a_b, D, w_in, NPROJ, big, NPROJ, LTOT, NPROJ, D);
        k_convmix<<<LTOT, 256, 0, stream>>>(big, conv_w, cm);
        k_attn<<<dim3(LTOT, H), 64, 0, stream>>>(big, lq1, lk1, lq2, lk2, subg, on);
        k_gemm<<<dim3(D / 128, MB), 256, 0, stream>>>(cm, D, w_co, D, ya, D, LTOT, D, D);
        k_gemm<<<dim3(D / 128, MB), 256, 0, stream>>>(on, D, w_ao, D, yb, D, LTOT, D, D);
        k_merge<<<LTOT, 256, 0, stream>>>(big, ya, yb, mg);
        k_gemm<<<dim3(D / 128, MB), 256, 0, stream>>>(mg, D, w_mo, D, mix, D, LTOT, D, D);
        k_res_norm<<<LTOT, 256, 0, stream>>>(h_b, mix, g_mpost, h1, g_fpre, f);
        k_gemm<<<dim3(NUP / 128, MB), 256, 0, stream>>>(f, D, w_up, NUP, big, NUP, LTOT, NUP, D);
        k_ffnact<<<LTOT, 256, 0, stream>>>(big, fcw, fcb, act);
        k_gemm<<<dim3(D / 128, MB), 256, 0, stream>>>(act, DFF, w_dn, D, y, D, LTOT, D, DFF);
        k_final<<<SEQ, 256, 0, stream>>>(h1, y, g_fpost, out + (size_t)b * SEQ * D);
    }
}
```
